# Optimizing an MI355X kernel written in HIP

```python
import jax, jax.numpy as jnp
from jax import lax
import numpy as np

D_MODEL = 1024
BATCH = 8
SEQ = 2048
DEPTH = 1

CTX_LEN = 256
GRID_W = 64

H_A = 8
DN_A = 64
DR_A = 32
DV_A = 64
W_A = H_A * DV_A
Q_LORA = 256
KV_LORA = 128
ROPE_FREQS = DR_A // 4
ROPE_BASE = 10000.0
Q_BLOCK = 128

H_B = 4
DH_B = 128
W_B = H_B * DH_B
QKV_BS = 4
N_QKV_BLK = W_B // QKV_BS
CONV_W = 3
CHUNK = 64

W_MIX = W_A + W_B
N_IN = Q_LORA + KV_LORA + DR_A + W_A + 3 * W_B
SPLITS = (Q_LORA,
          Q_LORA + KV_LORA,
          Q_LORA + KV_LORA + DR_A,
          Q_LORA + KV_LORA + DR_A + W_A,
          Q_LORA + KV_LORA + DR_A + W_A + W_B,
          Q_LORA + KV_LORA + DR_A + W_A + 2 * W_B)
ALPHA = (2.0 * DEPTH) ** 0.25
BETA = (8.0 * DEPTH) ** -0.25
LN_EPS = 1e-5
RMS_EPS = 1e-6

kernel_name = "hymba_mla_mlstm_prefix_dit_layer"


def layer_norm(x, eps=LN_EPS):
    xf = x.astype(jnp.float32)
    xc = xf - xf.mean(-1, keepdims=True)
    var = jnp.mean(xc * xc, -1, keepdims=True)
    return (xc * lax.rsqrt(var + eps)).astype(x.dtype)


def rms_norm(x, g, eps=RMS_EPS):
    xf = x.astype(jnp.float32)
    return (xf * lax.rsqrt(jnp.mean(xf * xf, -1, keepdims=True) + eps)).astype(x.dtype) * g


def axial_rope_tables(seq):
    n_rows = seq // GRID_W
    row = jnp.repeat(jnp.arange(n_rows, dtype=jnp.float32), GRID_W)
    col = jnp.tile(jnp.arange(GRID_W, dtype=jnp.float32), n_rows)
    inv = ROPE_BASE ** (-jnp.arange(ROPE_FREQS, dtype=jnp.float32) / ROPE_FREQS)
    ang = jnp.stack([row[:, None] * inv, col[:, None] * inv], axis=1)
    return jnp.cos(ang), jnp.sin(ang)


def rope2d(x, cos, sin):
    xs = x.reshape(x.shape[:-1] + (2, 2, ROPE_FREQS)).astype(jnp.float32)
    x1, x2 = xs[..., 0, :], xs[..., 1, :]
    out = jnp.stack([x1 * cos - x2 * sin, x2 * cos + x1 * sin], axis=-2)
    return out.reshape(x.shape).astype(x.dtype)


def mla_project(q_a, kv_a, k_r, g_qa, w_qb, g_kva, w_kvb):
    b, t, _ = q_a.shape
    q = (rms_norm(q_a, g_qa) @ w_qb).reshape(b, t, H_A, DN_A + DR_A)
    kv = (rms_norm(kv_a, g_kva) @ w_kvb).reshape(b, t, H_A, DN_A + DV_A)
    return q[..., :DN_A], q[..., DN_A:], kv[..., :DN_A], k_r, kv[..., DN_A:]


def block_attention(qn, qr, kn, kr, v):
    b, tq, h, _ = qn.shape
    nb = tq // Q_BLOCK
    scale = (DN_A + DR_A) ** -0.5
    qn_b = qn.reshape(b, nb, Q_BLOCK, h, DN_A).swapaxes(0, 1)
    qr_b = qr.reshape(b, nb, Q_BLOCK, h, DR_A).swapaxes(0, 1)

    def one_block(args):
        qn_i, qr_i = args
        s = jnp.einsum('bqhd,bkhd->bhqk', qn_i, kn) + jnp.einsum('bqhr,bkr->bhqk', qr_i, kr)
        p = jax.nn.softmax(s.astype(jnp.float32) * scale, axis=-1).astype(v.dtype)
        return jnp.einsum('bhqk,bkhd->bqhd', p, v)

    o = lax.map(one_block, (qn_b, qr_b))
    return o.swapaxes(0, 1).reshape(b, tq, h * DV_A)


def dwconv_centred(x, w, bias):
    t = x.shape[1]
    pad = CONV_W // 2
    xp = jnp.pad(x, ((0, 0), (pad, pad), (0, 0)))
    out = bias
    for j in range(CONV_W):
        out = out + xp[:, j:j + t] * w[j]
    return out


def headwise(x, w):
    b, t, _ = x.shape
    nb, bs, _ = w.shape
    return jnp.einsum('btgi,gio->btgo', x.reshape(b, t, nb, bs), w).reshape(b, t, nb * bs)


def to_heads(x):
    b, t, _ = x.shape
    return x.reshape(b, t, H_B, DH_B).transpose(0, 2, 1, 3)


def mlstm_inputs(x_m, conv_w, conv_b, w_mq, w_mk, w_mv, w_gate, b_gate):
    xc = jax.nn.silu(dwconv_centred(x_m, conv_w, conv_b))
    q = headwise(xc, w_mq)
    k = headwise(xc, w_mk)
    v = headwise(x_m, w_mv)
    g = (jnp.concatenate([q, k, v], -1) @ w_gate + b_gate).astype(jnp.float32)
    g = g.reshape(g.shape[0], g.shape[1], 4, H_B).transpose(2, 0, 3, 1)
    gates_f = (g[0], jax.nn.log_sigmoid(g[1]))
    gates_b = (g[2], jax.nn.log_sigmoid(g[3]))
    return xc, to_heads(q), to_heads(k * DH_B ** -0.5), to_heads(v), gates_f, gates_b


def zero_state(b):
    return (jnp.zeros((b, H_B, DH_B, DH_B), jnp.float32),
            jnp.zeros((b, H_B, DH_B), jnp.float32),
            jnp.zeros((b, H_B), jnp.float32))


def mlstm_final_state(k, v, li, lf, state):
    c0, n0, m0 = state
    bcum = jnp.cumsum(lf, axis=-1)
    b_end = bcum[..., -1]
    w = b_end[..., None] - bcum + li
    m = jnp.maximum(b_end + m0, w.max(-1))
    a0 = jnp.exp(b_end + m0 - m)
    ws = jnp.exp(w - m[..., None])
    c_new = a0[..., None, None] * c0 + jnp.einsum('bhs,bhsv,bhsd->bhvd', ws, v, k)
    n_new = a0[..., None] * n0 + jnp.einsum('bhs,bhsd->bhd', ws, k)
    return (c_new, n_new, m)


def mlstm_chunkwise(q, k, v, li, lf, state):
    b, h, t, _ = q.shape
    nc = t // CHUNK

    def split(a):
        return jnp.moveaxis(a.reshape(a.shape[:2] + (nc, CHUNK) + a.shape[3:]), 2, 0)

    mask = jnp.tril(jnp.ones((CHUNK, CHUNK), dtype=bool))

    def step(st, inp):
        c0, n0, m0 = st
        qc, kc, vc, lic, lfc = inp
        bcum = jnp.cumsum(lfc, axis=-1)
        dmat = jnp.where(mask, bcum[..., :, None] - bcum[..., None, :] + lic[..., None, :], -jnp.inf)
        inter = bcum + m0[..., None]
        m = jnp.maximum(inter, dmat.max(-1))
        a_inter = jnp.exp(inter - m)
        s = jnp.einsum('bhtd,bhsd->bhts', qc, kc) * jnp.exp(dmat - m[..., None])
        num = a_inter[..., None] * jnp.einsum('bhvd,bhtd->bhtv', c0, qc) + jnp.einsum('bhts,bhsv->bhtv', s, vc)
        den = a_inter * jnp.einsum('bhd,bhtd->bht', n0, qc) + s.sum(-1)
        h_chunk = num / jnp.maximum(jnp.abs(den), jnp.exp(-m))[..., None]
        return mlstm_final_state(kc, vc, lic, lfc, st), h_chunk

    st, hs = lax.scan(step, state, tuple(split(a) for a in (q, k, v, li, lf)))
    return jnp.moveaxis(hs, 0, 2).reshape(b, h, t, v.shape[-1]), st


def flip_t(a):
    return jnp.flip(a, axis=2)


def stream_tensors(u, w_in, g_qa, w_qb, g_kva, w_kvb, conv_w, conv_b, w_mq, w_mk, w_mv, w_gate, b_gate):
    p = u @ w_in
    q_a, kv_a, k_r, z_a, x_m, o_m, z_m = jnp.split(p, SPLITS, axis=-1)
    mla = mla_project(q_a, kv_a, k_r, g_qa, w_qb, g_kva, w_kvb)
    mls = mlstm_inputs(x_m, conv_w, conv_b, w_mq, w_mk, w_mv, w_gate, b_gate)
    return mla, mls, (z_a, o_m, z_m)


def mixer_output(att, z_a, h_cell, o_m, xc, z_m, mh_g, skip, w_out):
    b, _, t, _ = h_cell.shape
    hb = jax.nn.sigmoid(o_m) * h_cell.transpose(0, 2, 1, 3).reshape(b, t, W_B).astype(o_m.dtype)
    hb = layer_norm(hb.reshape(b, t, H_B, DH_B)).reshape(b, t, W_B) * mh_g + skip * xc
    y_a = att * jax.nn.silu(z_a)
    y_b = hb * jax.nn.silu(z_m)
    return jnp.concatenate([y_a, y_b], axis=-1) @ w_out


def hybrid_layer(h, hc, c, c_ctx, cos, sin, w_ada, b_ada, w_in, g_qa, w_qb, g_kva, w_kvb,
                 conv_w, conv_b, w_mq, w_mk, w_mv, w_gate, b_gate, mh_g, skip, w_out,
                 ln_g, ln_b, update_ctx):
    shift, scale, gate = jnp.split((jax.nn.silu(c) @ w_ada + b_ada)[:, None, :], 3, axis=-1)
    shift_c, scale_c, gate_c = jnp.split(jax.nn.silu(c_ctx) @ w_ada + b_ada, 3, axis=-1)
    weights = (w_in, g_qa, w_qb, g_kva, w_kvb, conv_w, conv_b, w_mq, w_mk, w_mv, w_gate, b_gate)

    (qn, qr, kn, kr, v), (xc, q, k, vm, gf, gb), (z_a, o_m, z_m) = stream_tensors(
        h * (1 + scale) + shift, *weights)
    (qn_c, qr_c, kn_c, kr_c, v_c), (xc_c, q_c, k_c, vm_c, gf_c, gb_c), (z_a_c, o_m_c, z_m_c) = stream_tensors(
        hc * (1 + scale_c) + shift_c, *weights)

    qr = rope2d(qr, cos[:, None], sin[:, None])
    kr = rope2d(kr, cos, sin)
    att = block_attention(qn, qr,
                          jnp.concatenate([kn_c, kn], axis=1),
                          jnp.concatenate([kr_c, kr], axis=1),
                          jnp.concatenate([v_c, v], axis=1))

    st0 = zero_state(h.shape[0])
    if update_ctx:
        h_cf, st_f = mlstm_chunkwise(q_c, k_c, vm_c, *gf_c, st0)
        h_cb, st_b = mlstm_chunkwise(*map(flip_t, (q_c, k_c, vm_c, *gb_c)), st0)
    else:
        st_f = mlstm_final_state(k_c, vm_c, *gf_c, st0)
        st_b = mlstm_final_state(*map(flip_t, (k_c, vm_c, *gb_c)), st0)
    h_f, _ = mlstm_chunkwise(q, k, vm, *gf, st_f)
    h_b, _ = mlstm_chunkwise(*map(flip_t, (q, k, vm, *gb)), st_b)

    y = mixer_output(att, z_a, h_f + flip_t(h_b), o_m, xc, z_m, mh_g, skip, w_out)
    h_new = layer_norm(ALPHA * h + gate * y) * ln_g + ln_b

    if update_ctx:
        att_c = block_attention(qn_c, qr_c, kn_c, kr_c, v_c)
        y_c = mixer_output(att_c, z_a_c, h_cf + flip_t(h_cb), o_m_c, xc_c, z_m_c, mh_g, skip, w_out)
        hc = layer_norm(ALPHA * hc + gate_c * y_c) * ln_g + ln_b
    return h_new, hc


def setup_inputs(seed: int = 0) -> dict:
    key = jax.random.key(seed)
    ks = jax.random.split(key, 32)
    L = DEPTH
    f32 = jnp.float32

    def nrm(k, shape, s):
        return jax.random.normal(k, shape, f32) * s

    f_bias = jnp.linspace(3.0, 6.0, H_B, dtype=f32)
    b_gate = jnp.concatenate([nrm(ks[20], (L, H_B), 0.1),
                              f_bias + nrm(ks[21], (L, H_B), 0.1),
                              nrm(ks[22], (L, H_B), 0.1),
                              f_bias + nrm(ks[23], (L, H_B), 0.1)], axis=-1)
    return {
        "x": nrm(ks[0], (BATCH, SEQ, D_MODEL), 1.0),
        "c": nrm(ks[1], (BATCH, D_MODEL), 1.0),
        "ctx": nrm(ks[2], (BATCH, CTX_LEN, D_MODEL), 1.0),
        "c_ctx": nrm(ks[3], (D_MODEL,), 1.0),
        "ln_in_g": 1.0 + nrm(ks[4], (D_MODEL,), 0.02),
        "ln_in_b": nrm(ks[5], (D_MODEL,), 0.02),
        "w_ada": nrm(ks[6], (L, D_MODEL, 3 * D_MODEL), 0.5 * D_MODEL ** -0.5),
        "b_ada": nrm(ks[7], (L, 3 * D_MODEL), 0.02),
        "w_in": nrm(ks[8], (L, D_MODEL, N_IN), D_MODEL ** -0.5),
        "g_qa": 1.0 + nrm(ks[9], (L, Q_LORA), 0.02),
        "w_qb": nrm(ks[10], (L, Q_LORA, H_A * (DN_A + DR_A)), Q_LORA ** -0.5),
        "g_kva": 1.0 + nrm(ks[11], (L, KV_LORA), 0.02),
        "w_kvb": nrm(ks[12], (L, KV_LORA, H_A * (DN_A + DV_A)), KV_LORA ** -0.5),
        "conv_w": nrm(ks[13], (L, CONV_W, W_B), CONV_W ** -0.5),
        "conv_b": nrm(ks[14], (L, W_B), 0.02),
        "w_mq": nrm(ks[15], (L, N_QKV_BLK, QKV_BS, QKV_BS), QKV_BS ** -0.5),
        "w_mk": nrm(ks[16], (L, N_QKV_BLK, QKV_BS, QKV_BS), QKV_BS ** -0.5),
        "w_mv": nrm(ks[17], (L, N_QKV_BLK, QKV_BS, QKV_BS), QKV_BS ** -0.5),
        "w_gate": nrm(ks[18], (L, 3 * W_B, 4 * H_B), (3 * W_B) ** -0.5),
        "b_gate": b_gate,
        "mh_g": 1.0 + nrm(ks[24], (L, W_B), 0.02),
        "skip": 1.0 + nrm(ks[25], (L, W_B), 0.02),
        "w_out": nrm(ks[26], (L, W_MIX, D_MODEL), BETA * W_MIX ** -0.5),
        "ln_g": 1.0 + nrm(ks[27], (L, D_MODEL), 0.02),
        "ln_b": nrm(ks[28], (L, D_MODEL), 0.02),
    }


def reference(x, c, ctx, c_ctx, ln_in_g, ln_in_b, w_ada, b_ada, w_in, g_qa, w_qb, g_kva, w_kvb,
              conv_w, conv_b, w_mq, w_mk, w_mv, w_gate, b_gate, mh_g, skip, w_out, ln_g, ln_b):
    cos, sin = axial_rope_tables(x.shape[1])
    h = layer_norm(x) * ln_in_g + ln_in_b
    hc = layer_norm(ctx) * ln_in_g + ln_in_b
    for l in range(DEPTH):
        h, hc = hybrid_layer(h, hc, c, c_ctx, cos, sin, w_ada[l], b_ada[l], w_in[l], g_qa[l], w_qb[l],
                             g_kva[l], w_kvb[l], conv_w[l], conv_b[l], w_mq[l], w_mk[l], w_mv[l],
                             w_gate[l], b_gate[l], mh_g[l], skip[l], w_out[l], ln_g[l], ln_b[l],
                             update_ctx=(l < DEPTH - 1))
    return h
```

```cpp
#include <hip/hip_runtime.h>
#include <cstdint>
#include <cstdio>

typedef unsigned short bf16_t;
__device__ __forceinline__ float bf2f(bf16_t v) { return __uint_as_float((unsigned)v << 16); }
__device__ __forceinline__ bf16_t f2bf(float f) { unsigned u = __float_as_uint(f); return (bf16_t)((u + 0x7fffu + ((u >> 16) & 1u)) >> 16); }
__device__ __forceinline__ float silu_f(float x) { return x / (1.f + __expf(-x)); }
__device__ __forceinline__ float sigmoid_f(float x) { return 1.f / (1.f + __expf(-x)); }
__device__ __forceinline__ float wave_sum(float v) {
#pragma unroll
    for (int o = 1; o < 64; o <<= 1) v += __shfl_xor(v, o);
    return v;
}

constexpr int NB = 8, TL = 2048, DM = 1024, TCX = 256;
constexpr int ML = NB * TL;
constexpr int MC = NB * TCX;
constexpr int MT = ML + MC;
constexpr int S2 = TCX + TL;
constexpr int NIN = 2464, NINP = 2560;
constexpr float LN_EPS = 1e-5f, RMS_EPS = 1e-6f;
constexpr float ALPHA = 1.189207115002721f;
constexpr float QSCALE = 0.10206207261596577f * 1.4426950408889634f;
constexpr float KSCALE = 0.08838834764831845f;

constexpr size_t MiB = 1u << 20;
constexpr size_t WS_CTL = 0;
constexpr size_t WS_MOD = 1 * MiB;
constexpr size_t WS_ROPE = WS_MOD + 128 * 1024;
constexpr size_t WS_XSTAT = WS_ROPE + 8 * 1024;
constexpr size_t WS_SSQ = WS_XSTAT + 128 * 1024;
constexpr size_t WS_MST = WS_SSQ + 144 * 1024;
constexpr size_t WS_WIN = 2 * MiB;
constexpr size_t WS_KR = WS_WIN;
constexpr size_t WS_GT = WS_WIN + 1179648;
constexpr size_t WS_NST = WS_GT + 1179648;
constexpr size_t WS_WQ = 7 * MiB;
constexpr size_t WS_WKV = WS_WQ + 393216;
constexpr size_t WS_WOUT = 8 * MiB;
constexpr size_t WS_U = 10 * MiB;
constexpr size_t WS_MIX = WS_U;
constexpr size_t WS_QA = 46 * MiB;
constexpr size_t WS_KVR = 54 * MiB;
constexpr size_t WS_XM = 63 * MiB;
constexpr size_t WS_HF = WS_QA;
constexpr size_t WS_HB = WS_QA + 16 * MiB;
constexpr size_t WS_ZA = 81 * MiB;
constexpr size_t WS_OM = 97 * MiB;
constexpr size_t WS_ZM = 113 * MiB;
constexpr size_t WS_Q = 129 * MiB;
constexpr size_t WS_KN = 153 * MiB;
constexpr size_t WS_VT = 171 * MiB;
constexpr size_t WS_XC = 189 * MiB;
constexpr size_t WS_QM = 205 * MiB;
constexpr size_t WS_KM = 221 * MiB;
constexpr size_t WS_KMT = 237 * MiB;
constexpr size_t WS_END = 255 * MiB;
constexpr size_t DO_CST = 0, DO_VMT = 32 * MiB;

struct Ptrs {
    const float *x, *c, *ctx, *c_ctx, *ln_in_g, *ln_in_b, *w_ada, *b_ada, *w_in, *g_qa, *w_qb, *g_kva, *w_kvb, *conv_w, *conv_b, *w_mq, *w_mk, *w_mv, *w_gate, *b_gate, *mh_g, *skip, *w_out, *ln_g, *ln_b;
    float* out; unsigned char* ws;
};
#define WSP(T, off) ((T*)(P.ws + (off)))

__device__ __forceinline__ int row_b(int row) { return row < ML ? row / TL : (row - ML) / TCX; }
__device__ __forceinline__ int row_s2(int row) { return row < ML ? TCX + row % TL : (row - ML) % TCX; }
__device__ __forceinline__ int s2_row(int b, int s2) { return s2 < TCX ? ML + b * TCX + s2 : b * TL + (s2 - TCX); }

__global__ void k_prep(Ptrs P) {
    const int gid = blockIdx.x * blockDim.x + threadIdx.x, gsz = gridDim.x * blockDim.x;
    bf16_t* win = WSP(bf16_t, WS_WIN);
    for (int i = gid; i < NINP * DM; i += gsz) { const int n = i / DM, k = i % DM; float v = 0.f;
        if (n < 416) v = P.w_in[(size_t)k * NIN + n]; else if (n >= 512) v = P.w_in[(size_t)k * NIN + (n - 96)];
        win[i] = f2bf(v); }
    bf16_t* wq = WSP(bf16_t, WS_WQ);
    for (int i = gid; i < 768 * 256; i += gsz) { const int n = i / 256, k = i % 256; wq[i] = f2bf(P.g_qa[k] * P.w_qb[k * 768 + n]); }
    bf16_t* wkv = WSP(bf16_t, WS_WKV);
    for (int i = gid; i < 1024 * 256; i += gsz) { const int n = i / 256, k = i % 256; wkv[i] = f2bf(k < 128 ? P.g_kva[k] * P.w_kvb[k * 1024 + n] : 0.f); }
    bf16_t* wo = WSP(bf16_t, WS_WOUT);
    for (int i = gid; i < 1024 * 1024; i += gsz) { const int n = i / 1024, k = i % 1024; wo[i] = f2bf(P.w_out[(size_t)k * 1024 + n]); }
    float* rope = WSP(float, WS_ROPE);
    for (int i = gid; i < 64 * 8; i += gsz) { const int pos = i / 8, f = i % 8; const float inv = powf(10000.f, -(float)f / 8.f); const float ang = (float)pos * inv;
        rope[2 * i] = cosf(ang); rope[2 * i + 1] = sinf(ang); }
    float* mod = WSP(float, WS_MOD);
    for (int i = gid; i < 9 * 3072; i += gsz) { const int b = i / 3072, j = i % 3072; const float* cv = b < 8 ? P.c + b * DM : P.c_ctx; float s = 0.f;
        for (int k = 0; k < DM; ++k) s += silu_f(cv[k]) * P.w_ada[(size_t)k * 3072 + j];
        mod[i] = s + P.b_ada[j]; }
}

__global__ void k_ln_u(Ptrs P) {
    const int lane = threadIdx.x & 63, gw = (blockIdx.x * blockDim.x + threadIdx.x) >> 6, nw = (gridDim.x * blockDim.x) >> 6;
    const float* mod = WSP(float, WS_MOD); bf16_t* U = WSP(bf16_t, WS_U); float* xs = WSP(float, WS_XSTAT);
    for (int row = gw; row < MT; row += nw) {
        const float* xr = row < ML ? P.x + (size_t)row * DM : P.ctx + (size_t)(row - ML) * DM;
        const int mb = row < ML ? row / TL : 8;
        float v[16]; float s = 0.f;
#pragma unroll
        for (int j = 0; j < 16; ++j) { v[j] = xr[lane + 64 * j]; s += v[j]; }
        const float mean = wave_sum(s) * (1.f / DM); float q = 0.f;
#pragma unroll
        for (int j = 0; j < 16; ++j) { v[j] -= mean; q += v[j] * v[j]; }
        const float rstd = rsqrtf(wave_sum(q) * (1.f / DM) + LN_EPS);
        if (row < ML && lane == 0) { xs[2 * row] = mean; xs[2 * row + 1] = rstd; }
#pragma unroll
        for (int j = 0; j < 16; ++j) { const int col = lane + 64 * j; const float h = v[j] * rstd * P.ln_in_g[col] + P.ln_in_b[col];
            U[(size_t)row * DM + col] = f2bf(h * (1.f + mod[mb * 3072 + 1024 + col]) + mod[mb * 3072 + col]); }
    }
}

struct GArgs { const bf16_t* A; const bf16_t* Bt; int lda, ldb, M, N, K, pad; };
template <class Epi>
__global__ void __launch_bounds__(256) k_gemm_naive(GArgs G, Ptrs P) {
    __shared__ float As[16][65], Bs[16][65];
    const bf16_t* A = G.A; const bf16_t* Bt = G.Bt; const int lda = G.lda, ldb = G.ldb, K = G.K; Epi epi;
    const int tx = threadIdx.x & 15, ty = threadIdx.x >> 4, m0 = blockIdx.y * 64, n0 = blockIdx.x * 64;
    float acc[4][4] = {};
    for (int k0 = 0; k0 < K; k0 += 16) {
        for (int i = threadIdx.x; i < 1024; i += 256) { const int r = i >> 4, kk = i & 15;
            As[kk][r] = bf2f(A[(size_t)(m0 + r) * lda + k0 + kk]); Bs[kk][r] = bf2f(Bt[(size_t)(n0 + r) * ldb + k0 + kk]); }
        __syncthreads();
#pragma unroll
        for (int kk = 0; kk < 16; ++kk) { float a[4], b[4];
#pragma unroll
            for (int i = 0; i < 4; ++i) { a[i] = As[kk][ty * 4 + i]; b[i] = Bs[kk][tx * 4 + i]; }
#pragma unroll
            for (int i = 0; i < 4; ++i)
#pragma unroll
                for (int j = 0; j < 4; ++j) acc[i][j] += a[i] * b[j]; }
        __syncthreads();
    }
#pragma unroll
    for (int i = 0; i < 4; ++i)
#pragma unroll
        for (int j = 0; j < 4; ++j) epi(P, m0 + ty * 4 + i, n0 + tx * 4 + j, acc[i][j]);
}

struct EpiIn {
    __device__ void operator()(const Ptrs& P, int row, int n, float v) const {
        const int t = n >> 8;
        if (t == 0) { if (row < ML) WSP(bf16_t, WS_QA)[(size_t)row * 256 + n] = f2bf(v); }
        else if (t == 1) WSP(bf16_t, WS_KVR)[(size_t)row * 256 + (n - 256)] = f2bf(v);
        else if (t < 4) { if (row < ML) WSP(bf16_t, WS_ZA)[(size_t)row * 512 + (n - 512)] = f2bf(silu_f(v)); }
        else if (t < 6) WSP(bf16_t, WS_XM)[(size_t)row * 512 + (n - 1024)] = f2bf(v);
        else if (t < 8) { if (row < ML) WSP(bf16_t, WS_OM)[(size_t)row * 512 + (n - 1536)] = f2bf(sigmoid_f(v)); }
        else { if (row < ML) WSP(bf16_t, WS_ZM)[(size_t)row * 512 + (n - 2048)] = f2bf(silu_f(v)); }
    }
};
struct EpiQ {
    __device__ void operator()(const Ptrs& P, int row, int n, float v) const {
        const float rstd = rsqrtf(WSP(float, WS_SSQ)[2 * row] * (1.f / 256.f) + RMS_EPS);
        WSP(bf16_t, WS_Q)[(size_t)row * 768 + n] = f2bf(v * rstd * QSCALE);
    }
};
struct EpiKV {
    __device__ void operator()(const Ptrs& P, int row, int n, float v) const {
        const float rstd = rsqrtf(WSP(float, WS_SSQ)[2 * row + 1] * (1.f / 128.f) + RMS_EPS);
        const int h = n >> 7, j = n & 127; const float o = v * rstd;
        if (j < 64) WSP(bf16_t, WS_KN)[(size_t)row * 512 + h * 64 + j] = f2bf(o);
        else WSP(bf16_t, WS_VT)[((size_t)(row_b(row) * 8 + h) * 64 + (j - 64)) * S2 + row_s2(row)] = f2bf(o);
    }
};
struct EpiOut {
    __device__ void operator()(const Ptrs& P, int row, int n, float v) const {
        const float* xs = WSP(float, WS_XSTAT); const float mean = xs[2 * row], rstd = xs[2 * row + 1];
        const float h = (P.x[(size_t)row * DM + n] - mean) * rstd * P.ln_in_g[n] + P.ln_in_b[n];
        const float gate = WSP(float, WS_MOD)[(row / TL) * 3072 + 2048 + n];
        P.out[(size_t)row * DM + n] = ALPHA * h + gate * v;
    }
};

__global__ void k_ssq(Ptrs P) {
    const int lane = threadIdx.x & 63, gw = (blockIdx.x * blockDim.x + threadIdx.x) >> 6, nw = (gridDim.x * blockDim.x) >> 6;
    float* ssq = WSP(float, WS_SSQ);
    for (int row = gw; row < MT; row += nw) {
        float s0 = 0.f, s1 = 0.f;
        if (row < ML) for (int j = 0; j < 4; ++j) { const float v = bf2f(WSP(bf16_t, WS_QA)[(size_t)row * 256 + lane + 64 * j]); s0 += v * v; }
        for (int j = 0; j < 2; ++j) { const float v = bf2f(WSP(bf16_t, WS_KVR)[(size_t)row * 256 + lane + 64 * j]); s1 += v * v; }
        s0 = wave_sum(s0); s1 = wave_sum(s1);
        if (lane == 0) { ssq[2 * row] = s0; ssq[2 * row + 1] = s1; }
    }
}

__global__ void k_rope(Ptrs P) {
    const int gid = blockIdx.x * blockDim.x + threadIdx.x, gsz = gridDim.x * blockDim.x;
    const float* rope = WSP(float, WS_ROPE);
    bf16_t* Q = WSP(bf16_t, WS_Q);
    for (int i = gid; i < ML * 8 * 16; i += gsz) {
        const int f = i & 7, a = (i >> 3) & 1, h = (i >> 4) & 7, row = i >> 7; const int t = row % TL; const int pos = a == 0 ? t / 64 : t % 64;
        const float cs = rope[2 * (pos * 8 + f)], sn = rope[2 * (pos * 8 + f) + 1];
        bf16_t* p = Q + (size_t)row * 768 + h * 96 + 64 + a * 16 + f;
        const float x1 = bf2f(p[0]), x2 = bf2f(p[8]);
        p[0] = f2bf(x1 * cs - x2 * sn); p[8] = f2bf(x2 * cs + x1 * sn);
    }
    bf16_t* KR = WSP(bf16_t, WS_KR); const bf16_t* KVR = WSP(bf16_t, WS_KVR);
    for (int i = gid; i < MT * 16; i += gsz) {
        const int f = i & 7, a = (i >> 3) & 1, row = i >> 4;
        const float x1 = bf2f(KVR[(size_t)row * 256 + 128 + a * 16 + f]), x2 = bf2f(KVR[(size_t)row * 256 + 128 + a * 16 + 8 + f]);
        float o1 = x1, o2 = x2;
        if (row < ML) { const int t = row % TL; const int pos = a == 0 ? t / 64 : t % 64; const float cs = rope[2 * (pos * 8 + f)], sn = rope[2 * (pos * 8 + f) + 1];
            o1 = x1 * cs - x2 * sn; o2 = x2 * cs + x1 * sn; }
        KR[(size_t)row * 32 + a * 16 + f] = f2bf(o1); KR[(size_t)row * 32 + a * 16 + 8 + f] = f2bf(o2);
    }
}

__global__ void __launch_bounds__(128) k_mprep(Ptrs P) {
    __shared__ float red[2][16];
    const int row = blockIdx.x, g = threadIdx.x, b = row_b(row), s2 = row_s2(row);
    const bf16_t* XM = WSP(bf16_t, WS_XM);
    const bool first = row < ML ? (row % TL == 0) : ((row - ML) % TCX == 0), last = row < ML ? (row % TL == TL - 1) : ((row - ML) % TCX == TCX - 1);
    float xm[4], xc[4];
#pragma unroll
    for (int i = 0; i < 4; ++i) { const int c = 4 * g + i; const float x0 = bf2f(XM[(size_t)row * 512 + c]);
        const float xp = first ? 0.f : bf2f(XM[(size_t)(row - 1) * 512 + c]), xn = last ? 0.f : bf2f(XM[(size_t)(row + 1) * 512 + c]);
        xm[i] = x0; xc[i] = silu_f(P.conv_b[c] + P.conv_w[c] * xp + P.conv_w[512 + c] * x0 + P.conv_w[1024 + c] * xn); }
    float q[4], k[4], v[4];
#pragma unroll
    for (int o = 0; o < 4; ++o) { float sq = 0.f, sk = 0.f, sv = 0.f;
#pragma unroll
        for (int i = 0; i < 4; ++i) { sq += xc[i] * P.w_mq[g * 16 + i * 4 + o]; sk += xc[i] * P.w_mk[g * 16 + i * 4 + o]; sv += xm[i] * P.w_mv[g * 16 + i * 4 + o]; }
        q[o] = sq; k[o] = sk; v[o] = sv; }
    float gs[16];
#pragma unroll
    for (int j = 0; j < 16; ++j) { float s = 0.f;
#pragma unroll
        for (int i = 0; i < 4; ++i) { const int c = 4 * g + i; s += q[i] * P.w_gate[c * 16 + j] + k[i] * P.w_gate[(512 + c) * 16 + j] + v[i] * P.w_gate[(1024 + c) * 16 + j]; }
        gs[j] = wave_sum(s); }
    if ((g & 63) == 0) for (int j = 0; j < 16; ++j) red[g >> 6][j] = gs[j];
    __syncthreads();
    if (g < 16) { float val = red[0][g] + red[1][g] + P.b_gate[g]; const int kind = g >> 2, h = g & 3;
        if (kind == 1 || kind == 3) val = fminf(val, 0.f) - log1pf(__expf(-fabsf(val)));
        WSP(float, WS_GT)[((size_t)(b * 4 + h) * 4 + kind) * S2 + s2] = val; }
    const int hh = (4 * g) >> 7, d0 = (4 * g) & 127;
    bf16_t* KMT = WSP(bf16_t, WS_KMT); bf16_t* VMT = (bf16_t*)((unsigned char*)P.out + DO_VMT);
#pragma unroll
    for (int i = 0; i < 4; ++i) { KMT[((size_t)(b * 4 + hh) * 128 + d0 + i) * S2 + s2] = f2bf(k[i] * KSCALE); VMT[((size_t)(b * 4 + hh) * 128 + d0 + i) * S2 + s2] = f2bf(v[i]); }
    if (row < ML) {
#pragma unroll
        for (int i = 0; i < 4; ++i) { const int c = 4 * g + i; WSP(bf16_t, WS_XC)[(size_t)row * 512 + c] = f2bf(xc[i]); WSP(bf16_t, WS_QM)[(size_t)row * 512 + c] = f2bf(q[i]); WSP(bf16_t, WS_KM)[(size_t)row * 512 + c] = f2bf(k[i] * KSCALE); }
    }
}

__global__ void __launch_bounds__(64) k_attn_naive(Ptrs P) {
    const int lane = threadIdx.x, blk = blockIdx.x, qb = blk & 31, h = (blk >> 5) & 7, b = blk >> 8;
    const int row = b * TL + qb * 64 + lane;
    const bf16_t* Q = WSP(bf16_t, WS_Q) + (size_t)row * 768 + h * 96;
    float q[96];
#pragma unroll
    for (int i = 0; i < 96; ++i) q[i] = bf2f(Q[i]);
    float o[64];
#pragma unroll
    for (int i = 0; i < 64; ++i) o[i] = 0.f;
    float m = -1e30f, l = 0.f;
    const bf16_t* KN = WSP(bf16_t, WS_KN); const bf16_t* KR = WSP(bf16_t, WS_KR); const bf16_t* VT = WSP(bf16_t, WS_VT) + (size_t)(b * 8 + h) * 64 * S2;
    for (int s2 = 0; s2 < S2; ++s2) {
        const int kr = s2_row(b, s2);
        const bf16_t* kn = KN + (size_t)kr * 512 + h * 64; const bf16_t* kp = KR + (size_t)kr * 32;
        float s = 0.f;
#pragma unroll
        for (int i = 0; i < 64; ++i) s += q[i] * bf2f(kn[i]);
#pragma unroll
        for (int i = 0; i < 32; ++i) s += q[64 + i] * bf2f(kp[i]);
        if (s > m) { const float c = exp2f(m - s); l *= c;
#pragma unroll
            for (int i = 0; i < 64; ++i) o[i] *= c;
            m = s; }
        const float p = exp2f(s - m); l += p;
#pragma unroll
        for (int i = 0; i < 64; ++i) o[i] += p * bf2f(VT[(size_t)i * S2 + s2]);
    }
    const float rl = 1.f / l;
    const bf16_t* ZA = WSP(bf16_t, WS_ZA) + (size_t)row * 512 + h * 64; bf16_t* MIX = WSP(bf16_t, WS_MIX) + (size_t)row * 1024 + h * 64;
#pragma unroll
    for (int i = 0; i < 64; ++i) MIX[i] = f2bf(o[i] * rl * bf2f(ZA[i]));
}

__global__ void __launch_bounds__(256) k_mlstm_naive(Ptrs P) {
    __shared__ float sk[128], sv[128], sq[128], sn[128], sg[2];
    const int tid = threadIdx.x, dir = blockIdx.x & 1, h = (blockIdx.x >> 1) & 3, b = blockIdx.x >> 3;
    const int v = tid >> 1, dh = tid & 1;
    const bf16_t* KMT = WSP(bf16_t, WS_KMT) + (size_t)(b * 4 + h) * 128 * S2; const bf16_t* VMT = (const bf16_t*)((unsigned char*)P.out + DO_VMT) + (size_t)(b * 4 + h) * 128 * S2;
    const float* GT = WSP(float, WS_GT) + (size_t)(b * 4 + h) * 4 * S2;
    bf16_t* HO = WSP(bf16_t, dir == 0 ? WS_HF : WS_HB);
    float C[64];
#pragma unroll
    for (int j = 0; j < 64; ++j) C[j] = 0.f;
    if (tid < 128) sn[tid] = 0.f;
    float m = 0.f;
    for (int i = 0; i < S2; ++i) {
        const int s2 = dir == 0 ? i : (i < TCX ? TCX - 1 - i : TCX + (TL - 1 - (i - TCX)));
        const bool lat = s2 >= TCX; const int row = b * TL + (s2 - TCX);
        __syncthreads();
        if (tid < 128) { sk[tid] = bf2f(KMT[(size_t)tid * S2 + s2]); if (lat) sq[tid] = bf2f(WSP(bf16_t, WS_QM)[(size_t)row * 512 + h * 128 + tid]); }
        else sv[tid - 128] = bf2f(VMT[(size_t)(tid - 128) * S2 + s2]);
        if (tid == 0) { sg[0] = GT[(size_t)(2 * dir) * S2 + s2]; sg[1] = GT[(size_t)(2 * dir + 1) * S2 + s2]; }
        __syncthreads();
        const float li = sg[0], lf = sg[1];
        const float mn = fmaxf(lf + m, li), fd = __expf(lf + m - mn), iw = __expf(li - mn);
        m = mn;
        const float vv = iw * sv[v];
        float hp = 0.f;
#pragma unroll
        for (int j = 0; j < 64; ++j) { C[j] = fd * C[j] + vv * sk[dh * 64 + j]; }
        if (tid < 128) sn[tid] = fd * sn[tid] + iw * sk[tid];
        if (lat) {
#pragma unroll
            for (int j = 0; j < 64; ++j) hp += C[j] * sq[dh * 64 + j];
            hp += __shfl_xor(hp, 1);
            __syncthreads();
            float den = 0.f;
            for (int d = 0; d < 128; ++d) den += sn[d] * sq[d];
            const float hv = hp / fmaxf(fabsf(den), __expf(-m));
            if (dh == 0) HO[(size_t)row * 512 + h * 128 + v] = f2bf(hv);
        }
    }
}

__global__ void k_mix_naive(Ptrs P) {
    const int lane = threadIdx.x & 63, gw = (blockIdx.x * blockDim.x + threadIdx.x) >> 6, nw = (gridDim.x * blockDim.x) >> 6;
    for (int it = gw; it < ML * 4; it += nw) {
        const int row = it >> 2, h = it & 3; const size_t base = (size_t)row * 512 + h * 128;
        float hb[2]; float s = 0.f;
#pragma unroll
        for (int j = 0; j < 2; ++j) { const int c = lane + 64 * j; hb[j] = bf2f(WSP(bf16_t, WS_OM)[base + c]) * (bf2f(WSP(bf16_t, WS_HF)[base + c]) + bf2f(WSP(bf16_t, WS_HB)[base + c])); s += hb[j]; }
        const float mean = wave_sum(s) * (1.f / 128.f); float q = 0.f;
#pragma unroll
        for (int j = 0; j < 2; ++j) { hb[j] -= mean; q += hb[j] * hb[j]; }
        const float rstd = rsqrtf(wave_sum(q) * (1.f / 128.f) + LN_EPS);
#pragma unroll
        for (int j = 0; j < 2; ++j) { const int c = lane + 64 * j, ch = h * 128 + c;
            const float y = (hb[j] * rstd * P.mh_g[ch] + P.skip[ch] * bf2f(WSP(bf16_t, WS_XC)[base + c])) * bf2f(WSP(bf16_t, WS_ZM)[base + c]);
            WSP(bf16_t, WS_MIX)[(size_t)row * 1024 + 512 + ch] = f2bf(y); }
    }
}

__global__ void k_ln_out(Ptrs P) {
    const int lane = threadIdx.x & 63, gw = (blockIdx.x * blockDim.x + threadIdx.x) >> 6, nw = (gridDim.x * blockDim.x) >> 6;
    for (int row = gw; row < ML; row += nw) {
        float* xr = P.out + (size_t)row * DM;
        float v[16]; float s = 0.f;
#pragma unroll
        for (int j = 0; j < 16; ++j) { v[j] = xr[lane + 64 * j]; s += v[j]; }
        const float mean = wave_sum(s) * (1.f / DM); float q = 0.f;
#pragma unroll
        for (int j = 0; j < 16; ++j) { v[j] -= mean; q += v[j] * v[j]; }
        const float rstd = rsqrtf(wave_sum(q) * (1.f / DM) + LN_EPS);
#pragma unroll
        for (int j = 0; j < 16; ++j) { const int col = lane + 64 * j; xr[col] = v[j] * rstd * P.ln_g[col] + P.ln_b[col]; }
    }
}

extern "C" void kernel_launch(void* const* d_in, const int* in_sizes, int n_in, void* d_out, int out_size, void* d_ws, size_t ws_size, hipStream_t stream) {
    if (n_in != 25 || out_size != ML * DM || ws_size < WS_END) { fprintf(stderr, "kernel_launch: unexpected shapes (n_in %d out %d ws %zu)\n", n_in, out_size, ws_size); return; }
    Ptrs P{};
    const float** pp = (const float**)&P;
    for (int i = 0; i < 25; ++i) pp[i] = (const float*)d_in[i];
    P.out = (float*)d_out; P.ws = (unsigned char*)d_ws;
    k_prep<<<1024, 256, 0, stream>>>(P);
    k_ln_u<<<1024, 256, 0, stream>>>(P);
    GArgs g1{}; g1.A = WSP(bf16_t, WS_U); g1.Bt = WSP(bf16_t, WS_WIN); g1.lda = DM; g1.ldb = DM; g1.M = MT; g1.N = NINP; g1.K = DM;
    GArgs g2{}; g2.A = WSP(bf16_t, WS_QA); g2.Bt = WSP(bf16_t, WS_WQ); g2.lda = 256; g2.ldb = 256; g2.M = ML; g2.N = 768; g2.K = 256;
    GArgs g3{}; g3.A = WSP(bf16_t, WS_KVR); g3.Bt = WSP(bf16_t, WS_WKV); g3.lda = 256; g3.ldb = 256; g3.M = MT; g3.N = 1024; g3.K = 256;
    GArgs g4{}; g4.A = WSP(bf16_t, WS_MIX); g4.Bt = WSP(bf16_t, WS_WOUT); g4.lda = DM; g4.ldb = DM; g4.M = ML; g4.N = DM; g4.K = DM;
    k_gemm_naive<EpiIn><<<dim3(NINP / 64, MT / 64), 256, 0, stream>>>(g1, P);
    k_ssq<<<1024, 256, 0, stream>>>(P);
    k_gemm_naive<EpiQ><<<dim3(768 / 64, ML / 64), 256, 0, stream>>>(g2, P);
    k_gemm_naive<EpiKV><<<dim3(1024 / 64, MT / 64), 256, 0, stream>>>(g3, P);
    k_mprep<<<MT, 128, 0, stream>>>(P);
    k_rope<<<1024, 256, 0, stream>>>(P);
    k_attn_naive<<<NB * 8 * 32, 64, 0, stream>>>(P);
    k_mlstm_naive<<<NB * 4 * 2, 256, 0, stream>>>(P);
    k_mix_naive<<<1024, 256, 0, stream>>>(P);
    k_gemm_naive<EpiOut><<<dim3(DM / 64, ML / 64), 256, 0, stream>>>(g4, P);
    k_ln_out<<<1024, 256, 0, stream>>>(P);
}
```
